# Optimizing an MI355X kernel written in HIP

```python
import math
import jax, jax.numpy as jnp
from jax import lax
import numpy as np

D_MODEL = 1024
BATCH = 4
SEQ = 8192
DEPTH = 1

EPS = 1e-6
NEG_INF = -1e30

ATTN_HEADS = 8
ATTN_KV_HEADS = 2
ATTN_HEAD_DIM = 64
ATTN_WIDTH = ATTN_HEADS * ATTN_HEAD_DIM
ATTN_KV_WIDTH = ATTN_KV_HEADS * ATTN_HEAD_DIM
WINDOW = 128
BLOCK = 128

NUM_BUCKETS = 32
MAX_DISTANCE = 128

GLA_HEADS = 4
GLA_KEY_DIM = 64
GLA_VALUE_DIM = 128
GLA_KEY_WIDTH = GLA_HEADS * GLA_KEY_DIM
GLA_WIDTH = GLA_HEADS * GLA_VALUE_DIM
GLA_GATE_RANK = 16
GLA_GATE_NORMALIZER = 16.0
GLA_CHUNK = 64

MIX_WIDTH = ATTN_WIDTH + GLA_WIDTH
SPLIT_SIZES = (ATTN_WIDTH, ATTN_KV_WIDTH, ATTN_KV_WIDTH, ATTN_WIDTH,
               GLA_KEY_WIDTH, GLA_KEY_WIDTH, GLA_WIDTH, GLA_WIDTH, GLA_GATE_RANK)
N_IN = sum(SPLIT_SIZES)

kernel_name = "hybrid_swa_sink_gla_parallel_heads"


def rmsnorm(x, gain):
    xf = x.astype(jnp.float32)
    y = xf * lax.rsqrt(jnp.mean(xf * xf, axis=-1, keepdims=True) + EPS) * gain.astype(jnp.float32)
    return y.astype(x.dtype)


def t5_causal_bucket(dist):
    n = jnp.maximum(dist, 0)
    max_exact = NUM_BUCKETS // 2
    nf = jnp.maximum(n, 1).astype(jnp.float32)
    large = max_exact + (jnp.log(nf / max_exact) / math.log(MAX_DISTANCE / max_exact)
                         * (NUM_BUCKETS - max_exact)).astype(jnp.int32)
    large = jnp.minimum(large, NUM_BUCKETS - 1)
    return jnp.where(n < max_exact, n, large)


def sliding_window_attention(q, k, v, sinks, rel_bias):
    B, S = q.shape[0], q.shape[1]
    nb = S // BLOCK
    G = ATTN_HEADS // ATTN_KV_HEADS
    qb = q.reshape(B, nb, BLOCK, ATTN_KV_HEADS, G, ATTN_HEAD_DIM)
    kb = k.reshape(B, nb, BLOCK, ATTN_KV_HEADS, ATTN_HEAD_DIM)
    vb = v.reshape(B, nb, BLOCK, ATTN_KV_HEADS, ATTN_HEAD_DIM)

    def with_prev(t):
        prev = jnp.concatenate([jnp.zeros_like(t[:, :1]), t[:, :-1]], axis=1)
        return jnp.concatenate([prev, t], axis=2)

    kw, vw = with_prev(kb), with_prev(vb)
    scale = ATTN_HEAD_DIM ** -0.5
    scores = jnp.einsum("bnqkgd,bnckd->bnkgqc", qb, kw).astype(jnp.float32) * scale

    qi = jnp.arange(BLOCK)
    ci = jnp.arange(2 * BLOCK)
    dist = qi[:, None] + BLOCK - ci[None, :]
    in_window = (dist >= 0) & (dist < WINDOW)
    bias = rel_bias.astype(jnp.float32)[t5_causal_bucket(dist)]
    bias = bias.transpose(2, 0, 1).reshape(ATTN_KV_HEADS, G, BLOCK, 2 * BLOCK)
    key_exists = (jnp.arange(nb)[:, None] > 0) | (ci[None, :] >= BLOCK)
    mask = in_window[None, :, :] & key_exists[:, None, :]

    scores = jnp.where(mask[None, :, None, None], scores + bias[None, None], NEG_INF)
    sink = sinks.astype(jnp.float32).reshape(ATTN_KV_HEADS, G)[None, None, :, :, None, None]
    m = jnp.maximum(jnp.max(scores, axis=-1, keepdims=True), sink)
    p = jnp.exp(scores - m)
    probs = p / (jnp.sum(p, axis=-1, keepdims=True) + jnp.exp(sink - m))
    out = jnp.einsum("bnkgqc,bnckd->bnqkgd", probs.astype(v.dtype), vw)
    return out.reshape(B, S, ATTN_WIDTH)


def gla_chunked(q, k, v, g):
    B, S = q.shape[0], q.shape[1]
    nc = S // GLA_CHUNK
    f32 = jnp.float32

    def rs(t):
        return t.astype(f32).reshape(B, nc, GLA_CHUNK, GLA_HEADS, t.shape[-1])

    qc = rs(q) * (GLA_KEY_DIM ** -0.5)
    kc, vc, gc = rs(k), rs(v), rs(g)
    b = jnp.cumsum(gc, axis=2)
    b_last = b[:, :, -1]
    q_dec = qc * jnp.exp(b)
    k_dec = kc * jnp.exp(-b)
    k_to_end = kc * jnp.exp(b_last[:, :, None] - b)

    causal = jnp.tril(jnp.ones((GLA_CHUNK, GLA_CHUNK), dtype=bool))
    A = jnp.where(causal, jnp.einsum("bnihd,bnjhd->bnhij", q_dec, k_dec), 0.0)
    o_intra = jnp.einsum("bnhij,bnjhv->bnihv", A, vc)
    kv_upd = jnp.einsum("bnjhd,bnjhv->bnhdv", k_to_end, vc)

    def step(state, inp):
        q_d, decay, upd = inp
        o = jnp.einsum("bihd,bhdv->bihv", q_d, state)
        return decay[..., None] * state + upd, o

    init = jnp.zeros((B, GLA_HEADS, GLA_KEY_DIM, GLA_VALUE_DIM), f32)
    xs = (jnp.moveaxis(q_dec, 1, 0), jnp.moveaxis(jnp.exp(b_last), 1, 0), jnp.moveaxis(kv_upd, 1, 0))
    _, o_inter = lax.scan(step, init, xs)
    o = o_intra + jnp.moveaxis(o_inter, 0, 1)
    return o.reshape(B, S, GLA_HEADS, GLA_VALUE_DIM).astype(q.dtype)


def hybrid_layer(x, norm_gain, w_in, w_gate_up, b_gate, rel_bias, sinks, gla_norm_gain, w_out):
    B, S = x.shape[0], x.shape[1]
    h = rmsnorm(x, norm_gain)
    proj = h @ w_in
    idx = list(np.cumsum(SPLIT_SIZES)[:-1])
    q_a, k_a, v_a, z_a, q_g, k_g, v_g, z_g, r_g = jnp.split(proj, idx, axis=-1)

    attn = sliding_window_attention(
        q_a.reshape(B, S, ATTN_HEADS, ATTN_HEAD_DIM),
        k_a.reshape(B, S, ATTN_KV_HEADS, ATTN_HEAD_DIM),
        v_a.reshape(B, S, ATTN_KV_HEADS, ATTN_HEAD_DIM),
        sinks, rel_bias)
    attn = attn * jax.nn.silu(z_a)

    gk = jax.nn.log_sigmoid((r_g @ w_gate_up + b_gate).astype(jnp.float32)) / GLA_GATE_NORMALIZER
    o = gla_chunked(
        q_g.reshape(B, S, GLA_HEADS, GLA_KEY_DIM),
        k_g.reshape(B, S, GLA_HEADS, GLA_KEY_DIM),
        v_g.reshape(B, S, GLA_HEADS, GLA_VALUE_DIM),
        gk.reshape(B, S, GLA_HEADS, GLA_KEY_DIM))
    gla = rmsnorm(o, gla_norm_gain).reshape(B, S, GLA_WIDTH) * jax.nn.silu(z_g)

    y = jnp.concatenate([attn, gla], axis=-1) @ w_out
    return x + y


def setup_inputs(seed: int = 0) -> dict:
    key = jax.random.key(seed)
    ks = jax.random.split(key, 11)
    nrm = jax.random.normal
    return {
        "x": nrm(ks[0], (BATCH, SEQ, D_MODEL), jnp.float32),
        "norm_gain": 1.0 + 0.01 * nrm(ks[1], (DEPTH, D_MODEL), jnp.float32),
        "w_in": nrm(ks[2], (DEPTH, D_MODEL, N_IN), jnp.float32) * D_MODEL ** -0.5,
        "w_gate_up": nrm(ks[3], (DEPTH, GLA_GATE_RANK, GLA_KEY_WIDTH), jnp.float32) * GLA_GATE_RANK ** -0.5,
        "b_gate": 0.1 * nrm(ks[4], (DEPTH, GLA_KEY_WIDTH), jnp.float32),
        "rel_bias": 0.1 * nrm(ks[5], (NUM_BUCKETS, ATTN_HEADS), jnp.float32),
        "sinks": 0.5 * nrm(ks[6], (DEPTH, ATTN_HEADS), jnp.float32),
        "gla_norm_gain": 1.0 + 0.01 * nrm(ks[7], (DEPTH, GLA_VALUE_DIM), jnp.float32),
        "w_out": nrm(ks[8], (DEPTH, MIX_WIDTH, D_MODEL), jnp.float32) * MIX_WIDTH ** -0.5,
        "final_norm_gain": 1.0 + 0.01 * nrm(ks[9], (D_MODEL,), jnp.float32),
    }


def reference(x, norm_gain, w_in, w_gate_up, b_gate, rel_bias, sinks, gla_norm_gain, w_out, final_norm_gain):
    for l in range(DEPTH):
        x = hybrid_layer(x, norm_gain[l], w_in[l], w_gate_up[l], b_gate[l], rel_bias,
                         sinks[l], gla_norm_gain[l], w_out[l])
    return rmsnorm(x, final_norm_gain)
```

```cpp
#include <hip/hip_runtime.h>
#include <cstdint>
#include <cstdio>

constexpr int BATCH = 4, SEQ = 8192, DM = 1024, M = BATCH * SEQ;
constexpr int AH = 8, AKV = 2, HD = 64, AW = 512, AKW = 128, BLK = 128;
constexpr int NBUCK = 32;
constexpr int GH = 4, GDK = 64, GDV = 128, GKW = 256, GW = 512, GR = 16, GCH = 64;
constexpr int NIN = 2832, NPAD = 3072, MIXW = 1024;
constexpr int C_QA = 0, C_KA = 512, C_VA = 640, C_ZA = 768, C_QG = 1280, C_KG = 1536, C_VG = 1792, C_ZG = 2304, C_RG = 2816;
constexpr float EPS = 1e-6f;
constexpr float LOG2E = 1.4426950408889634f;
constexpr float QS = 0.125f * LOG2E;

typedef unsigned short bf16;
__device__ __forceinline__ unsigned f2bf(float f) { unsigned u = __builtin_bit_cast(unsigned, f); return (u + 0x7fffu + ((u >> 16) & 1u)) >> 16; }
__device__ __forceinline__ float bf2f(bf16 b) { return __builtin_bit_cast(float, (unsigned)b << 16); }

constexpr size_t MiB = 1u << 20;
constexpr size_t WS_CTL = 0, WS_RSTD = 10 * MiB, WS_H = 32 * MiB, WS_PROJ = 96 * MiB, WS_MIX = 288 * MiB, WS_END = 352 * MiB;

__global__ void __launch_bounds__(256) nv_rstd(const float* __restrict__ x, float* __restrict__ rstd) {
    const int row = blockIdx.x * 4 + (threadIdx.x >> 6), lane = threadIdx.x & 63;
    const float4* xr = (const float4*)(x + (size_t)row * DM);
    float s = 0.f;
    for (int j = 0; j < 4; ++j) { float4 v = xr[lane + 64 * j]; s += v.x * v.x + v.y * v.y + v.z * v.z + v.w * v.w; }
    for (int o = 1; o < 64; o <<= 1) s += __shfl_xor(s, o);
    if (lane == 0) rstd[row] = 1.0f / sqrtf(s * (1.0f / DM) + EPS);
}

template <int MODE>
__global__ void __launch_bounds__(256) nv_gemm(const float* __restrict__ x, const float* __restrict__ rstd, const float* __restrict__ gain,
                                               const bf16* __restrict__ mix, const float* __restrict__ W, int N, bf16* __restrict__ proj, float* __restrict__ out) {
    __shared__ float As[16][68];
    __shared__ float Bs[16][68];
    const int tid = threadIdx.x, tx = tid & 15, ty = tid >> 4;
    const int m0 = blockIdx.y * 64, n0 = blockIdx.x * 64;
    float acc[4][4];
#pragma unroll
    for (int i = 0; i < 4; ++i)
#pragma unroll
        for (int j = 0; j < 4; ++j) acc[i][j] = 0.f;
    const int K = 1024;
    for (int k0 = 0; k0 < K; k0 += 16) {
#pragma unroll
        for (int i = 0; i < 4; ++i) {
            const int e = tid + i * 256, r = e >> 4, kk = e & 15;
            float a;
            if (MODE == 1) a = x[(size_t)(m0 + r) * DM + k0 + kk] * rstd[m0 + r] * gain[k0 + kk];
            else a = bf2f(mix[(size_t)(m0 + r) * MIXW + k0 + kk]);
            As[kk][r] = a;
        }
#pragma unroll
        for (int i = 0; i < 4; ++i) {
            const int e = tid + i * 256, kk = e >> 6, c = e & 63;
            Bs[kk][c] = (n0 + c < N) ? W[(size_t)(k0 + kk) * N + n0 + c] : 0.f;
        }
        __syncthreads();
#pragma unroll
        for (int kk = 0; kk < 16; ++kk) {
            float a[4], b[4];
#pragma unroll
            for (int i = 0; i < 4; ++i) { a[i] = As[kk][ty * 4 + i]; b[i] = Bs[kk][tx * 4 + i]; }
#pragma unroll
            for (int i = 0; i < 4; ++i)
#pragma unroll
                for (int j = 0; j < 4; ++j) acc[i][j] += a[i] * b[j];
        }
        __syncthreads();
    }
#pragma unroll
    for (int i = 0; i < 4; ++i)
#pragma unroll
        for (int j = 0; j < 4; ++j) {
            const int m = m0 + ty * 4 + i, n = n0 + tx * 4 + j;
            if (n < N) {
                if (MODE == 1) { float v = acc[i][j]; if (n < C_KA) v *= QS; proj[(size_t)m * NPAD + n] = (bf16)f2bf(v); }
                else out[(size_t)m * DM + n] = x[(size_t)m * DM + n] + acc[i][j];
            }
        }
}

__device__ __forceinline__ int t5_bucket(int dist) {
    if (dist < 16) return dist;
    int l = 16 + (int)(logf((float)dist / 16.0f) / 2.0794415416798357f * 16.0f);
    return l < 31 ? l : 31;
}
__device__ __forceinline__ float silu_f(float z) { return z / (1.0f + __expf(-z)); }

__global__ void __launch_bounds__(256) nv_attn(const bf16* __restrict__ proj, const float* __restrict__ rel_bias, const float* __restrict__ sinks, bf16* __restrict__ mix) {
    __shared__ float btab[AH][128];
    for (int i = threadIdx.x; i < AH * 128; i += 256) { const int hd = i >> 7, dist = i & 127; btab[hd][dist] = rel_bias[t5_bucket(dist) * AH + hd] * LOG2E; }
    __syncthreads();
    const int gid = blockIdx.x * 256 + threadIdx.x;
    const int hd = gid & 7, m = gid >> 3, t = m & (SEQ - 1), kvh = hd >> 2;
    float q[64], o[64];
    const bf16* qp = proj + (size_t)m * NPAD + C_QA + hd * 64;
#pragma unroll
    for (int d = 0; d < 64; ++d) { q[d] = bf2f(qp[d]); o[d] = 0.f; }
    const float sink2 = sinks[hd] * LOG2E;
    float mx = sink2, l = 0.f;
    const int tlo = t - 127 > 0 ? t - 127 : 0;
    for (int tk = tlo; tk <= t; ++tk) {
        const bf16* kp = proj + (size_t)(m - t + tk) * NPAD + C_KA + kvh * 64;
        const bf16* vp = proj + (size_t)(m - t + tk) * NPAD + C_VA + kvh * 64;
        float s = 0.f;
#pragma unroll
        for (int d = 0; d < 64; ++d) s += q[d] * bf2f(kp[d]);
        s += btab[hd][t - tk];
        const float mn = fmaxf(mx, s), f = exp2f(mx - mn), p = exp2f(s - mn);
        l = l * f + p; mx = mn;
#pragma unroll
        for (int d = 0; d < 64; ++d) o[d] = o[d] * f + p * bf2f(vp[d]);
    }
    const float inv = 1.0f / (l + exp2f(sink2 - mx));
    const bf16* zp = proj + (size_t)m * NPAD + C_ZA + hd * 64;
    bf16* op = mix + (size_t)m * MIXW + hd * 64;
#pragma unroll
    for (int d = 0; d < 64; ++d) op[d] = (bf16)f2bf(o[d] * inv * silu_f(bf2f(zp[d])));
}

__global__ void __launch_bounds__(128) nv_gla(const bf16* __restrict__ proj, const float* __restrict__ wg, const float* __restrict__ bg, const float* __restrict__ gng, bf16* __restrict__ mix) {
    __shared__ float sq[64], sk[64], sa[64], red[2];
    const int b = blockIdx.x >> 2, h = blockIdx.x & 3, v = threadIdx.x;
    float S[64];
#pragma unroll
    for (int c = 0; c < 64; ++c) S[c] = 0.f;
    float wcol[16]; float bgc = 0.f;
    if (v < 64) {
#pragma unroll
        for (int r = 0; r < 16; ++r) wcol[r] = wg[r * GKW + h * 64 + v];
        bgc = bg[h * 64 + v];
    }
    const float gn = gng[v];
    for (int t = 0; t < SEQ; ++t) {
        const size_t m = (size_t)b * SEQ + t;
        const bf16* row = proj + m * NPAD;
        if (v < 64) {
            float pre = bgc;
#pragma unroll
            for (int r = 0; r < 16; ++r) pre += bf2f(row[C_RG + r]) * wcol[r];
            const float ls = fminf(pre, 0.f) - log1pf(__expf(-fabsf(pre)));
            sa[v] = __expf(ls * (1.0f / 16.0f));
            sq[v] = bf2f(row[C_QG + h * 64 + v]) * 0.125f;
            sk[v] = bf2f(row[C_KG + h * 64 + v]);
        }
        const float vv = bf2f(row[C_VG + h * 128 + v]);
        __syncthreads();
        float o = 0.f;
#pragma unroll
        for (int c = 0; c < 64; ++c) { S[c] = sa[c] * S[c] + sk[c] * vv; o += sq[c] * S[c]; }
        float ss = o * o;
        for (int off = 1; off < 64; off <<= 1) ss += __shfl_xor(ss, off);
        if ((v & 63) == 0) red[v >> 6] = ss;
        __syncthreads();
        const float ms = (red[0] + red[1]) * (1.0f / 128.0f);
        const float z = bf2f(row[C_ZG + h * 128 + v]);
        mix[m * MIXW + AW + h * 128 + v] = (bf16)f2bf(o * (1.0f / sqrtf(ms + EPS)) * gn * silu_f(z));
    }
}

__global__ void __launch_bounds__(256) nv_final_norm(float* __restrict__ out, const float* __restrict__ gain) {
    const int row = blockIdx.x * 4 + (threadIdx.x >> 6), lane = threadIdx.x & 63;
    float4* xr = (float4*)(out + (size_t)row * DM);
    const float4* gr = (const float4*)gain;
    float4 v[4]; float s = 0.f;
    for (int j = 0; j < 4; ++j) { v[j] = xr[lane + 64 * j]; s += v[j].x * v[j].x + v[j].y * v[j].y + v[j].z * v[j].z + v[j].w * v[j].w; }
    for (int o = 1; o < 64; o <<= 1) s += __shfl_xor(s, o);
    const float r = 1.0f / sqrtf(s * (1.0f / DM) + EPS);
    for (int j = 0; j < 4; ++j) { const float4 g = gr[lane + 64 * j]; float4 w = v[j]; w.x *= r * g.x; w.y *= r * g.y; w.z *= r * g.z; w.w *= r * g.w; xr[lane + 64 * j] = w; }
}

extern "C" void kernel_launch(void* const* d_in, const int* in_sizes, int n_in, void* d_out, int out_size, void* d_ws, size_t ws_size, hipStream_t stream) {
    if (n_in != 10 || in_sizes[0] != M * DM || out_size != M * DM || ws_size < WS_END) { fprintf(stderr, "kernel_launch: unexpected shapes / workspace (%zu)\n", ws_size); return; }
    const float* x = (const float*)d_in[0]; const float* norm_gain = (const float*)d_in[1]; const float* w_in = (const float*)d_in[2];
    const float* w_gate_up = (const float*)d_in[3]; const float* b_gate = (const float*)d_in[4]; const float* rel_bias = (const float*)d_in[5];
    const float* sinks = (const float*)d_in[6]; const float* gla_norm_gain = (const float*)d_in[7]; const float* w_out = (const float*)d_in[8];
    const float* final_gain = (const float*)d_in[9];
    unsigned char* ws = (unsigned char*)d_ws; float* out = (float*)d_out;
    float* rstd = (float*)(ws + WS_RSTD); bf16* proj = (bf16*)(ws + WS_PROJ); bf16* mix = (bf16*)(ws + WS_MIX);
    nv_rstd<<<M / 4, 256, 0, stream>>>(x, rstd);
    nv_gemm<1><<<dim3((NIN + 63) / 64, M / 64), 256, 0, stream>>>(x, rstd, norm_gain, nullptr, w_in, NIN, proj, nullptr);
    nv_attn<<<M * AH / 256, 256, 0, stream>>>(proj, rel_bias, sinks, mix);
    nv_gla<<<BATCH * GH, 128, 0, stream>>>(proj, w_gate_up, b_gate, gla_norm_gain, mix);
    nv_gemm<2><<<dim3(DM / 64, M / 64), 256, 0, stream>>>(x, nullptr, nullptr, mix, w_out, DM, nullptr, out);
    nv_final_norm<<<M / 4, 256, 0, stream>>>(out, final_gain);
}
```
